# Optimizing an MI355X kernel written in HIP

```python
import math
import jax, jax.numpy as jnp
from jax import lax
import numpy as np

D_MODEL = 1024
BATCH = 16
SEQ = 4096
DEPTH = 1

CHUNK = 64
D_MIX = D_MODEL
LRU_WIDTH = D_MIX // 2
LRU_BLOCKS = 8
LRU_BLOCK = LRU_WIDTH // LRU_BLOCKS
CONV_WIDTH = 4
LRU_C = 8.0
SB_WIDTH = D_MIX - LRU_WIDTH
SB_HEADS = 8
SB_HEAD_DIM = SB_WIDTH // SB_HEADS
Q_BLOCK = 128
D_FF = 4 * D_MODEL
IN_COLS = 2 * LRU_WIDTH + 3 * SB_WIDTH
EPS = 1e-6

kernel_name = "hymba_rglru_stickbreaking_block"


def _rmsnorm(x, g):
    xf = x.astype(jnp.float32)
    y = xf * lax.rsqrt(jnp.mean(xf * xf, axis=-1, keepdims=True) + EPS)
    return (y * g.astype(jnp.float32)).astype(x.dtype)


def _causal_depthwise_conv(u, w, b):
    rhs = w[:, None, :].astype(u.dtype)
    y = lax.conv_general_dilated(
        u, rhs, window_strides=(1,), padding=[(CONV_WIDTH - 1, 0)],
        dimension_numbers=("NWC", "WIO", "NWC"), feature_group_count=u.shape[-1])
    return y + b.astype(u.dtype)


def _rg_lru(u, w_a, b_a, w_x, b_x, lam):
    B, S, _ = u.shape
    uf = u.astype(jnp.float32)
    ub = uf.reshape(B, S, LRU_BLOCKS, LRU_BLOCK)
    r = jax.nn.sigmoid(jnp.einsum('bsgi,gij->bsgj', ub, w_a.astype(jnp.float32))
                       + b_a.astype(jnp.float32)).reshape(B, S, LRU_WIDTH)
    i = jax.nn.sigmoid(jnp.einsum('bsgi,gij->bsgj', ub, w_x.astype(jnp.float32))
                       + b_x.astype(jnp.float32)).reshape(B, S, LRU_WIDTH)
    log_a = -LRU_C * r * jax.nn.softplus(-lam.astype(jnp.float32))
    a = jnp.exp(log_a)
    bterm = jnp.sqrt(-jnp.expm1(2.0 * log_a)) * (i * uf)

    def combine(left, right):
        a1, b1 = left
        a2, b2 = right
        return a1 * a2, a2 * b1 + b2

    _, h = lax.associative_scan(combine, (a, bterm), axis=1)
    return h.astype(u.dtype)


def _stick_breaking(q, k, v):
    B, S, H, Dh = q.shape
    scale = 1.0 / math.sqrt(Dh)
    qh = jnp.transpose(q, (0, 2, 1, 3)).astype(jnp.float32)
    kh = jnp.transpose(k, (0, 2, 1, 3)).astype(jnp.float32)
    vh = jnp.transpose(v, (0, 2, 1, 3)).astype(jnp.float32)
    outs = []
    for blk in range(S // Q_BLOCK):
        start = blk * Q_BLOCK
        end = start + Q_BLOCK
        qb = qh[:, :, start:end]
        kb = kh[:, :, :end]
        vb = vh[:, :, :end]
        z = jnp.einsum('bhqd,bhkd->bhqk', qb, kb) * scale
        t_idx = jnp.arange(start, end)[:, None]
        s_idx = jnp.arange(end)[None, :]
        mask = s_idx < t_idx
        log_1m_beta = jnp.where(mask, jax.nn.log_sigmoid(-z), 0.0)
        surv = lax.cumsum(log_1m_beta, axis=3, reverse=True) - log_1m_beta
        att = jnp.where(mask, jnp.exp(jax.nn.log_sigmoid(z) + surv), 0.0)
        outs.append(jnp.einsum('bhqk,bhkd->bhqd', att, vb))
    o = jnp.concatenate(outs, axis=2)
    return jnp.transpose(o, (0, 2, 1, 3)).reshape(B, S, H * Dh).astype(q.dtype)


def setup_inputs(seed: int = 0) -> dict:
    key = jax.random.key(seed)
    ks = jax.random.split(key, 20)
    f32 = jnp.float32
    x = jax.random.normal(ks[0], (BATCH, SEQ, D_MODEL), f32)
    norm1_g = 1.0 + 0.01 * jax.random.normal(ks[1], (DEPTH, D_MODEL), f32)
    w_in = jax.random.normal(ks[2], (DEPTH, D_MODEL, IN_COLS), f32) * D_MODEL ** -0.5
    conv_w = jax.random.normal(ks[3], (DEPTH, CONV_WIDTH, LRU_WIDTH), f32) * CONV_WIDTH ** -0.5
    conv_b = 0.01 * jax.random.normal(ks[4], (DEPTH, LRU_WIDTH), f32)
    lru_w_a = jax.random.normal(ks[5], (DEPTH, LRU_BLOCKS, LRU_BLOCK, LRU_BLOCK), f32) * LRU_BLOCK ** -0.5
    lru_b_a = 0.01 * jax.random.normal(ks[6], (DEPTH, LRU_BLOCKS, LRU_BLOCK), f32)
    lru_w_x = jax.random.normal(ks[7], (DEPTH, LRU_BLOCKS, LRU_BLOCK, LRU_BLOCK), f32) * LRU_BLOCK ** -0.5
    lru_b_x = 0.01 * jax.random.normal(ks[8], (DEPTH, LRU_BLOCKS, LRU_BLOCK), f32)
    u = jax.random.uniform(ks[9], (DEPTH, LRU_WIDTH), f32, 0.9, 0.999)
    a0 = u ** (1.0 / LRU_C)
    lru_lambda = jnp.log(a0) - jnp.log1p(-a0)
    lru_out_g = 1.0 + 0.01 * jax.random.normal(ks[10], (DEPTH, LRU_WIDTH), f32)
    sb_out_g = 1.0 + 0.01 * jax.random.normal(ks[11], (DEPTH, SB_WIDTH), f32)
    w_out = jax.random.normal(ks[12], (DEPTH, D_MIX, D_MODEL), f32) * D_MIX ** -0.5
    norm2_g = 1.0 + 0.01 * jax.random.normal(ks[13], (DEPTH, D_MODEL), f32)
    w_up = jax.random.normal(ks[14], (DEPTH, D_MODEL, D_FF), f32) * D_MODEL ** -0.5
    w_down = jax.random.normal(ks[15], (DEPTH, D_FF, D_MODEL), f32) * D_FF ** -0.5
    final_g = 1.0 + 0.01 * jax.random.normal(ks[16], (D_MODEL,), f32)
    return {"x": x, "norm1_g": norm1_g, "w_in": w_in, "conv_w": conv_w, "conv_b": conv_b,
            "lru_w_a": lru_w_a, "lru_b_a": lru_b_a, "lru_w_x": lru_w_x, "lru_b_x": lru_b_x,
            "lru_lambda": lru_lambda, "lru_out_g": lru_out_g, "sb_out_g": sb_out_g,
            "w_out": w_out, "norm2_g": norm2_g, "w_up": w_up, "w_down": w_down,
            "final_g": final_g}


def reference(x, norm1_g, w_in, conv_w, conv_b, lru_w_a, lru_b_a, lru_w_x, lru_b_x,
              lru_lambda, lru_out_g, sb_out_g, w_out, norm2_g, w_up, w_down, final_g):
    B, S, _ = x.shape
    split_pts = [LRU_WIDTH, 2 * LRU_WIDTH, 2 * LRU_WIDTH + SB_WIDTH, 2 * LRU_WIDTH + 2 * SB_WIDTH]
    h = x
    for layer in range(DEPTH):
        xn = _rmsnorm(h, norm1_g[layer])
        proj = xn @ w_in[layer].astype(xn.dtype)
        x_lru, g_lru, q, k, v = jnp.split(proj, split_pts, axis=-1)
        c = _causal_depthwise_conv(x_lru, conv_w[layer], conv_b[layer])
        y_lru = _rg_lru(c, lru_w_a[layer], lru_b_a[layer], lru_w_x[layer], lru_b_x[layer],
                        lru_lambda[layer]) * jax.nn.gelu(g_lru, approximate=True)
        y_sb = _stick_breaking(q.reshape(B, S, SB_HEADS, SB_HEAD_DIM),
                               k.reshape(B, S, SB_HEADS, SB_HEAD_DIM),
                               v.reshape(B, S, SB_HEADS, SB_HEAD_DIM))
        mix = jnp.concatenate([_rmsnorm(y_lru, lru_out_g[layer]),
                               _rmsnorm(y_sb, sb_out_g[layer])], axis=-1)
        h = h + mix @ w_out[layer].astype(mix.dtype)
        hn = _rmsnorm(h, norm2_g[layer])
        up = jax.nn.relu(hn @ w_up[layer].astype(hn.dtype))
        h = h + (up * up) @ w_down[layer].astype(up.dtype)
    return _rmsnorm(h, final_g)
```

```cpp
#include <hip/hip_runtime.h>
#include <hip/hip_cooperative_groups.h>
#include <cstdio>
#include <cstdint>
namespace cg = cooperative_groups;
namespace pg8 {
#define PG8_LAS __attribute__((address_space(3)))
typedef unsigned short bf16_t;
typedef short bf16x8 __attribute__((ext_vector_type(8)));
typedef float f32x4 __attribute__((ext_vector_type(4)));
typedef unsigned u32x4 __attribute__((ext_vector_type(4)));
constexpr int BM = 256, BK = 64, HALF = 128, HTB = HALF * BK * 2  , STAGE_BYTES = 8 * HTB, NXCD = 8, WGM = 8;

__host__ __device__ __forceinline__ int lds_byte(int r, int c) { const int st = (r >> 4) * 2 + (c >> 5), rr = r & 15, cc = c & 31, ob = rr * 64 + cc * 2; return st * 1024 + (ob ^ (((ob >> 9) & 1) << 5)); }
__host__ __device__ __forceinline__ void stage_rc(int b, int& R, int& C) { const int st = b / 1024, sb = b % 1024, swz = sb ^ (((sb >> 9) & 1) << 5); R = (st >> 1) * 16 + swz / 64; C = (st & 1) * 32 + (swz % 64) / 2; }
__host__ __device__ __forceinline__ int perm32(int rho) { const int n = rho >> 4, i = rho & 15; return 8 * (i >> 2) + 4 * n + (i & 3); }

struct Unit { int pm, pn; };
struct Gemm { const bf16_t* A; const bf16_t* Bt; int M, N, K; };

struct StaticOrder {
    int nM, nN, nwg, G, c;
    __host__ __device__ void init(int M, int N, int G_, int c_) { nM = M / BM; nN = N / BM; nwg = nM * nN; G = G_; c = c_; }
    __host__ __device__ bool next(int i, Unit& u) const {
        const long L = (long)i * G + c; if (L >= nwg) return false;
        int wgid = (int)L; { const int q = nwg / NXCD, r = nwg % NXCD, xcd = wgid % NXCD, off = wgid / NXCD; wgid = (xcd < r ? xcd * (q + 1) : r * (q + 1) + (xcd - r) * q) + off; }
        const int nig = WGM * nN, gid = wgid / nig, fm = gid * WGM, gsz = (nM - fm) < WGM ? (nM - fm) : WGM;
        u.pm = fm + ((wgid % nig) % gsz); u.pn = (wgid % nig) / gsz; return true;
    }
    __device__ __forceinline__ void a_ready(const Unit&) const {}
    __device__ __forceinline__ void done(const Unit&) const {}
};

__device__ __forceinline__ unsigned cvt_pk_bf16(float lo, float hi) { unsigned r; asm volatile("v_cvt_pk_bf16_f32 %0, %1, %2" : "=v"(r) : "v"(lo), "v"(hi)); return r; }

typedef float f32x2 __attribute__((ext_vector_type(2)));
__device__ __forceinline__ unsigned f2bf_u(float f) { unsigned u = __builtin_bit_cast(unsigned, f); return (u + 0x7fffu + ((u >> 16) & 1u)) >> 16; }

struct RowOrder {
    int pm, nN;
    __device__ __forceinline__ bool next(int i, Unit& u) const { if (i >= nN) return false; int p = pm; asm volatile("" : "+s"(p)); u.pm = p; u.pn = i; return true; }
    __device__ __forceinline__ void a_ready(const Unit&) const {}
    __device__ __forceinline__ void done(const Unit&) const {}
};

struct EpiInProj {
    static constexpr bool PERM = true, AFTER_DRAIN = false, MID = false;
    bf16_t* P; bf16_t* VT; float qscale;
    __device__ __forceinline__ void mid(f32x4 (&acc)[2][2][4][2], const Unit& u, int wr, int fr) const {}
    __device__ __forceinline__ void operator()(const f32x4 (&acc)[2][2][4][2], const Unit& u, int wr, int wc, int fr_in, int fq) const {
        int fr = fr_in; asm volatile("" : "+v"(fr));
        const int row0 = u.pm * BM + wr * 64 + fr;
        if (u.pn < 8) {
            const float sc = (u.pn == 4 || u.pn == 5) ? qscale : 1.f;
            const int col0 = u.pn * BM + wc * 32 + 8 * fq;
#pragma unroll
            for (int ai = 0; ai < 2; ++ai)
#pragma unroll
                for (int m = 0; m < 4; ++m) { bf16_t* rowp = P + (size_t)(row0 + ai * HALF + m * 16) * 2048 + col0;
#pragma unroll
                    for (int bj = 0; bj < 2; ++bj) { f32x4 v0 = acc[ai][bj][m][0] * sc, v1 = acc[ai][bj][m][1] * sc;
                        u32x4 w; w.x = cvt_pk_bf16(v0[0], v0[1]); w.y = cvt_pk_bf16(v0[2], v0[3]); w.z = cvt_pk_bf16(v1[0], v1[1]); w.w = cvt_pk_bf16(v1[2], v1[3]);
                        *(u32x4*)(rowp + bj * HALF) = w; } }
        } else {
            const int cv0 = (u.pn - 8) * BM + wc * 32 + 8 * fq;
#pragma unroll
            for (int ai = 0; ai < 2; ++ai)
#pragma unroll
                for (int m = 0; m < 4; ++m) { const int row = row0 + ai * HALF + m * 16; const int b = row >> 12, s = row & 4095;
#pragma unroll
                    for (int bj = 0; bj < 2; ++bj)
#pragma unroll
                        for (int n = 0; n < 2; ++n)
#pragma unroll
                            for (int j = 0; j < 4; ++j) { const int cv = cv0 + bj * HALF + 4 * n + j;
                                VT[((size_t)(b * 512 + cv) << 12) + s] = (bf16_t)f2bf_u(acc[ai][bj][m][n][j]); } }
        }
    }
};

struct EpiOut {
    static constexpr bool PERM = true, AFTER_DRAIN = false, MID = true;
    const float* x; float* h; bf16_t* hn; const PG8_LAS float* scl; PG8_LAS float* part;
    __device__ __forceinline__ void mid(f32x4 (&acc)[2][2][4][2], const Unit& u, int wr, int fr) const {
#pragma unroll
        for (int ai = 0; ai < 2; ++ai)
#pragma unroll
            for (int m = 0; m < 4; ++m) { const float s = scl[(ai * HALF + wr * 64 + m * 16 + fr) * 2];
#pragma unroll
                for (int bj = 0; bj < 2; ++bj)
#pragma unroll
                    for (int n = 0; n < 2; ++n) acc[ai][bj][m][n] = acc[ai][bj][m][n] * s; }
    }
    __device__ __forceinline__ void operator()(const f32x4 (&acc)[2][2][4][2], const Unit& u, int wr, int wc, int fr_in, int fq) const {
        int fr = fr_in; asm volatile("" : "+v"(fr));
#pragma unroll
        for (int ai = 0; ai < 2; ++ai)
#pragma unroll
            for (int m = 0; m < 4; ++m) { const int rl = ai * HALF + wr * 64 + m * 16 + fr; const size_t row = (size_t)u.pm * BM + rl; const float s = scl[rl * 2 + 1]; float ss = 0.f;
#pragma unroll
                for (int bj = 0; bj < 2; ++bj) { const size_t off = row * 1024 + u.pn * BM + bj * HALF + wc * 32 + 8 * fq;
                    const f32x4 x0 = *(const f32x4*)(x + off), x1 = *(const f32x4*)(x + off + 4);
                    const f32x4 v0 = x0 + acc[ai][bj][m][0] * s, v1 = x1 + acc[ai][bj][m][1] * s;
                    *(f32x4*)(h + off) = v0; *(f32x4*)(h + off + 4) = v1;
                    ss += (v0[0] * v0[0] + v0[1] * v0[1]) + (v0[2] * v0[2] + v0[3] * v0[3]) + (v1[0] * v1[0] + v1[1] * v1[1]) + (v1[2] * v1[2] + v1[3] * v1[3]);
                    u32x4 w; w.x = cvt_pk_bf16(v0[0], v0[1]); w.y = cvt_pk_bf16(v0[2], v0[3]); w.z = cvt_pk_bf16(v1[0], v1[1]); w.w = cvt_pk_bf16(v1[2], v1[3]);
                    *(u32x4*)(hn + off) = w; }
                ss += __shfl_xor(ss, 16); ss += __shfl_xor(ss, 32);
                if (fq == 0) part[(u.pn * 4 + wc) * 256 + rl] = ss;
                asm volatile("" ::: "memory"); }
    }
};

struct EpiUp {
    static constexpr bool PERM = true, AFTER_DRAIN = false, MID = false;
    bf16_t* U; const PG8_LAS float* rs;
    __device__ __forceinline__ void mid(f32x4 (&acc)[2][2][4][2], const Unit& u, int wr, int fr) const {}
    __device__ __forceinline__ void operator()(const f32x4 (&acc)[2][2][4][2], const Unit& u, int wr, int wc, int fr_in, int fq) const {
        int fr = fr_in; asm volatile("" : "+v"(fr));
#pragma unroll
        for (int ai = 0; ai < 2; ++ai)
#pragma unroll
            for (int m = 0; m < 4; ++m) { const int rl = ai * HALF + wr * 64 + m * 16 + fr; const float s = rs[rl];
                bf16_t* rowp = U + ((size_t)u.pm * BM + rl) * 4096 + u.pn * BM + wc * 32 + 8 * fq;
#pragma unroll
                for (int bj = 0; bj < 2; ++bj) { f32x4 v0 = acc[ai][bj][m][0] * s, v1 = acc[ai][bj][m][1] * s;
                    v0 = __builtin_elementwise_max(v0, (f32x4){0.f, 0.f, 0.f, 0.f}); v1 = __builtin_elementwise_max(v1, (f32x4){0.f, 0.f, 0.f, 0.f}); v0 = v0 * v0; v1 = v1 * v1;
                    u32x4 w; w.x = cvt_pk_bf16(v0[0], v0[1]); w.y = cvt_pk_bf16(v0[2], v0[3]); w.z = cvt_pk_bf16(v1[0], v1[1]); w.w = cvt_pk_bf16(v1[2], v1[3]);
                    *(u32x4*)(rowp + bj * HALF) = w; } }
    }
};

struct EpiDown {
    static constexpr bool PERM = true, AFTER_DRAIN = false, MID = false;
    float* h; PG8_LAS float* part;
    __device__ __forceinline__ void mid(f32x4 (&acc)[2][2][4][2], const Unit& u, int wr, int fr) const {}
    __device__ __forceinline__ void operator()(const f32x4 (&acc)[2][2][4][2], const Unit& u, int wr, int wc, int fr_in, int fq) const {
        int fr = fr_in; asm volatile("" : "+v"(fr));
#pragma unroll
        for (int ai = 0; ai < 2; ++ai)
#pragma unroll
            for (int m = 0; m < 4; ++m) { const int rl = ai * HALF + wr * 64 + m * 16 + fr; const size_t row = (size_t)u.pm * BM + rl; float ss = 0.f;
#pragma unroll
                for (int bj = 0; bj < 2; ++bj) { const size_t off = row * 1024 + u.pn * BM + bj * HALF + wc * 32 + 8 * fq;
                    const f32x4 x0 = *(const f32x4*)(h + off), x1 = *(const f32x4*)(h + off + 4);
                    const f32x4 v0 = x0 + acc[ai][bj][m][0], v1 = x1 + acc[ai][bj][m][1];
                    *(f32x4*)(h + off) = v0; *(f32x4*)(h + off + 4) = v1;
                    ss += (v0[0] * v0[0] + v0[1] * v0[1]) + (v0[2] * v0[2] + v0[3] * v0[3]) + (v1[0] * v1[0] + v1[1] * v1[1]) + (v1[2] * v1[2] + v1[3] * v1[3]); }
                ss += __shfl_xor(ss, 16); ss += __shfl_xor(ss, 32);
                if (fq == 0) part[(u.pn * 4 + wc) * 256 + rl] = ss;
                asm volatile("" ::: "memory"); }
    }
};

template <class Epi, class Sched, bool ALIGN_EPI = false, bool SP2 = false>
__device__ __forceinline__ void gemm_phase(PG8_LAS unsigned char* lds, const Gemm g, const Sched& S, const Epi& E) {
    int tid = threadIdx.x; asm volatile("" : "+v"(tid));
    const int wid = __builtin_amdgcn_readfirstlane(tid >> 6), lane = tid & 63, wr = wid >> 2, wc = wid & 3, fr = lane & 15, fq = lane >> 4;
    const int K = g.K, nt = K / BK;
    unsigned voffA[2], voffB[2];
#pragma unroll
    for (int i = 0; i < 2; ++i) { int R, C; stage_rc(tid * 16 + i * 8192, R, C); const int Rb = Epi::PERM ? ((R & ~31) + perm32(R & 31)) : R;
        voffA[i] = (unsigned)(R * K + C) * 2u; voffB[i] = (unsigned)(Rb * K + C) * 2u; }
    const size_t kstep = (size_t)(BK * 2);
    const size_t hstep = (size_t)HALF * K * 2;
    const size_t tstep = 2 * hstep;
    const unsigned ldsw = (unsigned)wid * 1024u;
    const int aoff = lds_byte(wr * 64 + fr, fq * 8), boff = lds_byte(wc * 32 + fr, fq * 8);
#define PG8_SA(b, h) (((b) * 2 + (h)) * HTB)
#define PG8_SB(b, h) ((4 + (b) * 2 + (h)) * HTB)
#define PG8_STAGE(bufoff, gbase, voff) do { _Pragma("unroll") for (int _i = 0; _i < 2; ++_i) \
        __builtin_amdgcn_global_load_lds((const unsigned*)((const char*)(gbase) + (voff)[_i]), (PG8_LAS unsigned*)(lds + (bufoff) + ldsw + _i * 8192), 16, 0, 0); } while (0)
#define PG8_LDA(dst, b, h) do { _Pragma("unroll") for (int m = 0; m < 4; ++m) _Pragma("unroll") for (int k = 0; k < 2; ++k) dst[m][k] = *(const PG8_LAS bf16x8*)(lds + PG8_SA(b, h) + aoff + m * 2048 + k * 1024); } while (0)
#define PG8_LDB(dst, b, h) do { _Pragma("unroll") for (int n = 0; n < 2; ++n) _Pragma("unroll") for (int k = 0; k < 2; ++k) dst[n][k] = *(const PG8_LAS bf16x8*)(lds + PG8_SB(b, h) + boff + n * 2048 + k * 1024); } while (0)
#define PG8_MMA(ai, bj, At, Bt) do { __builtin_amdgcn_s_setprio(1); _Pragma("unroll") for (int m = 0; m < 4; ++m) _Pragma("unroll") for (int n = 0; n < 2; ++n) _Pragma("unroll") for (int k = 0; k < 2; ++k) \
        acc[ai][bj][m][n] = __builtin_amdgcn_mfma_f32_16x16x32_bf16(Bt[n][k], At[m][k], acc[ai][bj][m][n], 0, 0, 0); __builtin_amdgcn_s_setprio(0); } while (0)
#define PG8_WAIT_V(n) asm volatile("s_waitcnt vmcnt(" #n ")" ::: "memory")
#define PG8_WAIT_L(n) asm volatile("s_waitcnt lgkmcnt(" #n ")" ::: "memory")
#define PG8_BAR __builtin_amdgcn_s_barrier()
#define PG8_SCHED __builtin_amdgcn_sched_barrier(0)
    Unit cur, nxt; int ui = 0;
    if (!S.next(0, cur)) return;
    f32x4 acc[2][2][4][2];
#pragma unroll
    for (int a = 0; a < 2; ++a)
#pragma unroll
        for (int b = 0; b < 2; ++b)
#pragma unroll
            for (int m = 0; m < 4; ++m)
#pragma unroll
                for (int n = 0; n < 2; ++n) acc[a][b][m][n] = (f32x4){0.f, 0.f, 0.f, 0.f};
    bf16x8 At[4][2], B0[2][2], B1[2][2];
    const char* cA = (const char*)g.A + (size_t)cur.pm * tstep; const char* cB = (const char*)g.Bt + (size_t)cur.pn * tstep;
    S.a_ready(cur);
    if constexpr (SP2) {
        PG8_STAGE(PG8_SB(0, 0), cB, voffB); PG8_STAGE(PG8_SB(0, 1), cB + hstep, voffB); PG8_STAGE(PG8_SA(0, 0), cA, voffA); PG8_STAGE(PG8_SA(0, 1), cA + hstep, voffA);
        if (wr == 1) PG8_BAR;
        PG8_WAIT_V(2); PG8_BAR;
        PG8_STAGE(PG8_SB(1, 0), cB + kstep, voffB); PG8_STAGE(PG8_SA(1, 0), cA + kstep, voffA); PG8_STAGE(PG8_SB(1, 1), cB + hstep + kstep, voffB);
        PG8_WAIT_V(6); PG8_BAR;
    } else {
        PG8_STAGE(PG8_SB(0, 0), cB, voffB); PG8_STAGE(PG8_SA(0, 0), cA, voffA); PG8_STAGE(PG8_SB(0, 1), cB + hstep, voffB); PG8_STAGE(PG8_SA(0, 1), cA + hstep, voffA);
        if (wr == 1) PG8_BAR;
        PG8_WAIT_V(4); PG8_BAR;
        PG8_STAGE(PG8_SB(1, 0), cB + kstep, voffB); PG8_STAGE(PG8_SA(1, 0), cA + kstep, voffA); PG8_STAGE(PG8_SB(1, 1), cB + hstep + kstep, voffB);
        PG8_WAIT_V(6); PG8_BAR;
    }
    for (;;) {
        const bool has_next = S.next(ui + 1, nxt);
        const char* nA = has_next ? (const char*)g.A + (size_t)nxt.pm * tstep : cA; const char* nB = has_next ? (const char*)g.Bt + (size_t)nxt.pn * tstep : cB;
        for (int t = 0; t < nt; t += 2) {
            const bool last = (t == nt - 2);
            const char* a1 = cA + (size_t)(t + 1) * kstep;
            const char* a2 = last ? nA : cA + (size_t)(t + 2) * kstep; const char* b2 = last ? nB : cB + (size_t)(t + 2) * kstep;
            const char* a3 = a2 + kstep; const char* b3 = b2 + kstep;
            if (last && has_next) S.a_ready(nxt);
            if constexpr (Epi::MID) { if (t == nt / 2) E.mid(acc, cur, wr, fr); }
            if constexpr (SP2) {
            PG8_LDB(B0, 0, 0); PG8_LDB(B1, 0, 1); PG8_SCHED; PG8_LDA(At, 0, 0); PG8_STAGE(PG8_SA(1, 1), a1 + hstep, voffA);
            PG8_WAIT_V(8); PG8_WAIT_L(0); PG8_BAR; PG8_MMA(0, 0, At, B0); PG8_MMA(0, 1, At, B1); PG8_BAR; PG8_SCHED;
            PG8_LDA(At, 0, 1); PG8_STAGE(PG8_SB(0, 0), b2, voffB); PG8_STAGE(PG8_SB(0, 1), b2 + hstep, voffB); PG8_STAGE(PG8_SA(0, 0), a2, voffA);
            PG8_WAIT_V(8); PG8_WAIT_L(0); PG8_BAR; PG8_MMA(1, 0, At, B0); PG8_MMA(1, 1, At, B1); PG8_BAR; PG8_SCHED;
            PG8_LDB(B0, 1, 0); PG8_LDB(B1, 1, 1); PG8_SCHED; PG8_LDA(At, 1, 0); PG8_STAGE(PG8_SA(0, 1), a2 + hstep, voffA);
            PG8_WAIT_V(8); PG8_WAIT_L(0); PG8_BAR; PG8_MMA(0, 0, At, B0); PG8_MMA(0, 1, At, B1); PG8_BAR; PG8_SCHED;
            PG8_LDA(At, 1, 1); PG8_STAGE(PG8_SB(1, 0), b3, voffB); PG8_STAGE(PG8_SB(1, 1), b3 + hstep, voffB); PG8_STAGE(PG8_SA(1, 0), a3, voffA);
            PG8_WAIT_V(8); PG8_WAIT_L(0); PG8_BAR; PG8_MMA(1, 0, At, B0); PG8_MMA(1, 1, At, B1); PG8_BAR; PG8_SCHED;
            } else {
            PG8_LDB(B0, 0, 0); PG8_SCHED; PG8_LDA(At, 0, 0); PG8_STAGE(PG8_SA(1, 1), a1 + hstep, voffA);
            PG8_WAIT_L(8); PG8_BAR; PG8_WAIT_L(0); PG8_MMA(0, 0, At, B0); PG8_BAR; PG8_SCHED;
            PG8_LDB(B1, 0, 1); PG8_STAGE(PG8_SB(0, 0), b2, voffB);
            PG8_BAR; PG8_WAIT_L(0); PG8_MMA(0, 1, At, B1); PG8_BAR;
            PG8_LDA(At, 0, 1); PG8_STAGE(PG8_SA(0, 0), a2, voffA);
            PG8_BAR; PG8_WAIT_L(0); PG8_MMA(1, 0, At, B0); PG8_BAR; PG8_SCHED;
            PG8_STAGE(PG8_SB(0, 1), b2 + hstep, voffB);
            PG8_WAIT_V(6); PG8_BAR; PG8_MMA(1, 1, At, B1); PG8_BAR;
            PG8_LDB(B0, 1, 0); PG8_SCHED; PG8_LDA(At, 1, 0); PG8_STAGE(PG8_SA(0, 1), a2 + hstep, voffA);
            PG8_WAIT_L(8); PG8_BAR; PG8_WAIT_L(0); PG8_MMA(0, 0, At, B0); PG8_BAR; PG8_SCHED;
            PG8_LDB(B1, 1, 1); PG8_STAGE(PG8_SB(1, 0), b3, voffB);
            PG8_BAR; PG8_WAIT_L(0); PG8_MMA(0, 1, At, B1); PG8_BAR;
            PG8_LDA(At, 1, 1); PG8_STAGE(PG8_SA(1, 0), a3, voffA);
            PG8_BAR; PG8_WAIT_L(0); PG8_MMA(1, 0, At, B0); PG8_BAR; PG8_SCHED;
            PG8_STAGE(PG8_SB(1, 1), b3 + hstep, voffB);
            PG8_WAIT_V(6); PG8_BAR; PG8_MMA(1, 1, At, B1); PG8_BAR;
            }
        }
        if constexpr (ALIGN_EPI) { if (wr == 0) PG8_BAR; }
        if constexpr (!Epi::AFTER_DRAIN) { E(acc, cur, wr, wc, fr, fq); S.done(cur); }
        if (!has_next) break;
#pragma unroll
        for (int a = 0; a < 2; ++a)
#pragma unroll
            for (int b = 0; b < 2; ++b)
#pragma unroll
                for (int m = 0; m < 4; ++m)
#pragma unroll
                    for (int n = 0; n < 2; ++n) acc[a][b][m][n] = (f32x4){0.f, 0.f, 0.f, 0.f};
        cur = nxt; cA = nA; cB = nB; ++ui;
        if constexpr (ALIGN_EPI) { if (wr == 1) PG8_BAR; }
    }
    PG8_WAIT_V(0);
    if constexpr (!ALIGN_EPI) { if (wr == 0) PG8_BAR; }
    PG8_BAR;
    if constexpr (Epi::AFTER_DRAIN) { E.fused(acc, cur, wr, wc, fr, fq, lds, wid, lane); S.done(cur); }
#undef PG8_SA
#undef PG8_SB
#undef PG8_STAGE
#undef PG8_LDA
#undef PG8_LDB
#undef PG8_MMA
#undef PG8_WAIT_V
#undef PG8_WAIT_L
#undef PG8_BAR
#undef PG8_SCHED
}
}

constexpr int NB = 16, SEQ = 4096, DM = 1024, NIN = 2560, FF = 4096, LW = 512;
constexpr int M = NB * SEQ;
constexpr float EPS = 1e-6f;
constexpr float LOG2E = 1.4426950408889634f;
constexpr float ATT_THR = 5.9604645e-8f;
constexpr size_t MiB = 1u << 20;
constexpr size_t WS_WIN = 0, WS_WOUT = 5 * MiB, WS_WUP = 7 * MiB, WS_WDN = 15 * MiB;
constexpr size_t WS_WA = 23 * MiB, WS_WX = WS_WA + 65536;
constexpr size_t WS_CA2 = WS_WX + 65536;
constexpr size_t WS_AGGP = 24 * MiB, WS_AGGH = 26 * MiB;
constexpr size_t WS_XN = 32 * MiB;
constexpr size_t WS_Y = 160 * MiB;
constexpr size_t WS_HG = 288 * MiB, WS_PG = 352 * MiB;
constexpr size_t WS_PROJ = 416 * MiB;
constexpr size_t WS_VT = 672 * MiB;
constexpr size_t WS_U = 416 * MiB;
constexpr size_t WS_END = 928 * MiB;
constexpr int LDS_PART = 131072, LDS_SCL = LDS_PART + 16384, LDS_RS = LDS_SCL + 2048, LDS_BYTES = LDS_RS + 1024;

#define LAS __attribute__((address_space(3)))
typedef unsigned short bf16;
typedef unsigned v4u __attribute__((ext_vector_type(4)));
typedef float f32x4 __attribute__((ext_vector_type(4)));
typedef float f32x16 __attribute__((ext_vector_type(16)));
typedef short bf16x8 __attribute__((ext_vector_type(8)));
typedef __bf16 bf16x2_t __attribute__((ext_vector_type(2)));
typedef float f32x2_t __attribute__((ext_vector_type(2)));

__device__ __forceinline__ unsigned pk2(float lo, float hi) { f32x2_t v = {lo, hi}; bf16x2_t b = __builtin_convertvector(v, bf16x2_t); return __builtin_bit_cast(unsigned, b); }
__device__ __forceinline__ unsigned f2bf_dev(float f) { unsigned u = __builtin_bit_cast(unsigned, f); return (u + 0x7fffu + ((u >> 16) & 1u)) >> 16; }
__device__ __forceinline__ float bflo(unsigned w) { return __builtin_bit_cast(float, w << 16); }
__device__ __forceinline__ float bfhi(unsigned w) { return __builtin_bit_cast(float, w & 0xffff0000u); }
__device__ __forceinline__ float wave_sum(float v) {
#pragma unroll
    for (int o = 1; o < 64; o <<= 1) v += __shfl_xor(v, o);
    return v;
}
template <int CTRL> __device__ __forceinline__ float dppf(float old, float src) {
    return __builtin_bit_cast(float, __builtin_amdgcn_update_dpp(__builtin_bit_cast(int, old), __builtin_bit_cast(int, src), CTRL, 0xf, 0xf, false));
}

struct Args { const float* in[17]; float* out; unsigned char* ws; };

__device__ __forceinline__ void p0_transpose_item(const float* W, int K, int N, bf16* WT, const float* gk, LAS float* scr, int item, int lane) {
    const int nblk = N / 32, kb = item / nblk, nb = item % nblk, k0 = 64 * kb, n0 = 32 * nb;
#pragma unroll 8
    for (int i = 0; i < 32; ++i) { const int kk = 2 * i + (lane >> 5); const float g = gk ? gk[k0 + kk] : 1.f; scr[kk * 33 + (lane & 31)] = W[(size_t)(k0 + kk) * N + n0 + (lane & 31)] * g; }
    asm volatile("s_waitcnt lgkmcnt(0)" ::: "memory");
    const int c = lane & 7;
#pragma unroll
    for (int j = 0; j < 4; ++j) { const int n = (lane >> 3) + 8 * j; const LAS float* s = scr + (8 * c) * 33 + n;
        v4u o; o.x = pk2(s[0 * 33], s[1 * 33]); o.y = pk2(s[2 * 33], s[3 * 33]); o.z = pk2(s[4 * 33], s[5 * 33]); o.w = pk2(s[6 * 33], s[7 * 33]);
        *(v4u*)(WT + (size_t)(n0 + n) * K + k0 + 8 * c) = o; }
    asm volatile("s_waitcnt lgkmcnt(0)" ::: "memory");
}

__device__ __forceinline__ void lru_item(const bf16* __restrict__ PROJ, const bf16* __restrict__ WAt, const bf16* __restrict__ WXt, const float* __restrict__ ba, const float* __restrict__ bx,
                                         const float* __restrict__ ca2, const LAS float* cwl, bf16* __restrict__ HG, bf16* __restrict__ PG, float* __restrict__ AGGP, float* __restrict__ AGGH,
                                         int b, int c, int g, int lane) {
    const int n = lane & 15, q = lane >> 4;
    const size_t R0 = (size_t)b * SEQ + c * 64;
    bf16x8 wa[4][2], wx[4][2];
#pragma unroll
    for (int mt = 0; mt < 4; ++mt)
#pragma unroll
        for (int ks = 0; ks < 2; ++ks) { const int oc = 16 * (n >> 2) + 4 * mt + (n & 3); const size_t o = ((size_t)g * 64 + oc) * 64 + 32 * ks + 8 * q;
            wa[mt][ks] = *(const bf16x8*)(WAt + o); wx[mt][ks] = *(const bf16x8*)(WXt + o); }
    f32x4 prevP[4], prevH[4];
#pragma unroll
    for (int mt = 0; mt < 4; ++mt) { prevP[mt] = (f32x4){1.f, 1.f, 1.f, 1.f}; prevH[mt] = (f32x4){0.f, 0.f, 0.f, 0.f}; }
    const LAS float* lcon = cwl + 2560 + 64 * g + 16 * q;
#pragma unroll 1
    for (int nt = 0; nt < 4; ++nt) {
        const int tt = c * 64 + 16 * nt + n;
        const bf16* xrow = PROJ + (R0 + 16 * nt + n) * 2048 + 64 * g;
        bf16x8 uf[2], gf[2];
#pragma unroll
        for (int ks = 0; ks < 2; ++ks) { const int cin = 32 * ks + 8 * q;
            gf[ks] = *(const bf16x8*)(xrow + 512 + cin);
            f32x4 u0 = *(const LAS f32x4*)(cwl + 2048 + 64 * g + cin), u1 = *(const LAS f32x4*)(cwl + 2048 + 64 * g + cin + 4);
#pragma unroll
            for (int k = 0; k < 4; ++k) { const int back = 3 - k; const bool ok = tt >= back; const v4u xv = *(const v4u*)(xrow - (ok ? back : 0) * 2048 + cin);
                f32x4 w0 = *(const LAS f32x4*)(cwl + k * 512 + 64 * g + cin), w1 = *(const LAS f32x4*)(cwl + k * 512 + 64 * g + cin + 4);
                if (!ok) { w0 = (f32x4){0.f, 0.f, 0.f, 0.f}; w1 = w0; }
                u0 += w0 * (f32x4){bflo(xv.x), bfhi(xv.x), bflo(xv.y), bfhi(xv.y)}; u1 += w1 * (f32x4){bflo(xv.z), bfhi(xv.z), bflo(xv.w), bfhi(xv.w)}; }
            v4u p; p.x = pk2(u0[0], u0[1]); p.y = pk2(u0[2], u0[3]); p.z = pk2(u1[0], u1[1]); p.w = pk2(u1[2], u1[3]); uf[ks] = __builtin_bit_cast(bf16x8, p); }
        v4u oh[2], op[2];
#pragma unroll
        for (int mt = 0; mt < 4; ++mt) {
            f32x4 aR = {0.f, 0.f, 0.f, 0.f}, aI = aR, aU = aR, aG = aR;
#pragma unroll
            for (int ks = 0; ks < 2; ++ks) { const int tgt = 16 * (n >> 2) + 4 * mt + (n & 3) - 32 * ks - 8 * q; v4u iw;
                iw.x = (tgt >> 1) == 0 ? ((tgt & 1) ? 0x3F800000u : 0x3F80u) : 0u; iw.y = (tgt >> 1) == 1 ? ((tgt & 1) ? 0x3F800000u : 0x3F80u) : 0u;
                iw.z = (tgt >> 1) == 2 ? ((tgt & 1) ? 0x3F800000u : 0x3F80u) : 0u; iw.w = (tgt >> 1) == 3 ? ((tgt & 1) ? 0x3F800000u : 0x3F80u) : 0u;
                const bf16x8 idf = __builtin_bit_cast(bf16x8, iw);
                aR = __builtin_amdgcn_mfma_f32_16x16x32_bf16(wa[mt][ks], uf[ks], aR, 0, 0, 0); aI = __builtin_amdgcn_mfma_f32_16x16x32_bf16(wx[mt][ks], uf[ks], aI, 0, 0, 0);
                aU = __builtin_amdgcn_mfma_f32_16x16x32_bf16(idf, uf[ks], aU, 0, 0, 0);        aG = __builtin_amdgcn_mfma_f32_16x16x32_bf16(idf, gf[ks], aG, 0, 0, 0); }
            float hg[4], pg[4];
            const f32x4 cba_ = *(const LAS f32x4*)(lcon + 4 * mt), cbx_ = *(const LAS f32x4*)(lcon + 512 + 4 * mt), cca_ = *(const LAS f32x4*)(lcon + 1024 + 4 * mt);
#pragma unroll
            for (int j = 0; j < 4; ++j) {
                const float r = __builtin_amdgcn_rcpf(1.f + __builtin_amdgcn_exp2f(-LOG2E * (aR[j] + cba_[j])));
                const float ig = __builtin_amdgcn_rcpf(1.f + __builtin_amdgcn_exp2f(-LOG2E * (aI[j] + cbx_[j])));
                const float a_ = __builtin_amdgcn_exp2f(r * cca_[j]);
                const float b_ = __builtin_amdgcn_sqrtf(fmaxf(1.f - a_ * a_, 0.f)) * (ig * aU[j]);
                const float gv = aG[j];
                const float gg = gv * __builtin_amdgcn_rcpf(1.f + __builtin_amdgcn_exp2f(-LOG2E * 1.5957691216f * gv * (1.f + 0.044715f * gv * gv)));
                const float cP = dppf<0x10F>(1.f, prevP[mt][j]), cH = dppf<0x10F>(0.f, prevH[mt][j]);
                float P = a_ * cP, H = a_ * cH + b_;
                { const float Ps = dppf<0x111>(1.f, P), Hs = dppf<0x111>(0.f, H); H = P * Hs + H; P = P * Ps; }
                { const float Ps = dppf<0x112>(1.f, P), Hs = dppf<0x112>(0.f, H); H = P * Hs + H; P = P * Ps; }
                { const float Ps = dppf<0x114>(1.f, P), Hs = dppf<0x114>(0.f, H); H = P * Hs + H; P = P * Ps; }
                { const float Ps = dppf<0x118>(1.f, P), Hs = dppf<0x118>(0.f, H); H = P * Hs + H; P = P * Ps; }
                prevP[mt][j] = P; prevH[mt][j] = H; hg[j] = H * gg; pg[j] = P * gg;
            }
            const unsigned h01 = pk2(hg[0], hg[1]), h23 = pk2(hg[2], hg[3]), p01 = pk2(pg[0], pg[1]), p23 = pk2(pg[2], pg[3]);
            if (mt == 0) { oh[0].x = h01; oh[0].y = h23; op[0].x = p01; op[0].y = p23; } else if (mt == 1) { oh[0].z = h01; oh[0].w = h23; op[0].z = p01; op[0].w = p23; }
            else if (mt == 2) { oh[1].x = h01; oh[1].y = h23; op[1].x = p01; op[1].y = p23; } else { oh[1].z = h01; oh[1].w = h23; op[1].z = p01; op[1].w = p23; }
            __builtin_amdgcn_sched_barrier(0);
        }
        const unsigned o = (unsigned)((16 * nt + n) * 512 + 64 * g + 16 * q);
        bf16* hgp = HG + R0 * 512; bf16* pgp = PG + R0 * 512;
        *(v4u*)(hgp + o) = oh[0]; *(v4u*)(hgp + o + 8) = oh[1]; *(v4u*)(pgp + o) = op[0]; *(v4u*)(pgp + o + 8) = op[1];
    }
    if (n == 15) { const size_t o = ((size_t)b * 64 + c) * 512 + 64 * g + 16 * q;
#pragma unroll
        for (int mt = 0; mt < 4; ++mt) { *(f32x4*)(AGGP + o + 4 * mt) = prevP[mt]; *(f32x4*)(AGGH + o + 4 * mt) = prevH[mt]; } }
}

__device__ __forceinline__ void attn_item(const bf16* __restrict__ PROJ, const bf16* __restrict__ VT, bf16* __restrict__ Y, int b, int qt, int h, int lane) {
    const int r = lane & 31, hh = lane >> 5;
    const size_t RB = (size_t)b * SEQ; const int q0 = qt * 64;
    bf16x8 qf[2][4];
#pragma unroll
    for (int qs = 0; qs < 2; ++qs)
#pragma unroll
        for (int ks = 0; ks < 4; ++ks) qf[qs][ks] = *(const bf16x8*)(PROJ + (RB + q0 + 32 * qs + r) * 2048 + 1024 + 64 * h + 16 * ks + 8 * hh);
    f32x16 O[2][2];
#pragma unroll
    for (int a = 0; a < 2; ++a)
#pragma unroll
        for (int d = 0; d < 2; ++d)
#pragma unroll
            for (int i = 0; i < 16; ++i) O[a][d][i] = 0.f;
    float R0 = 1.f, R1 = 1.f;
    const int kperm = 16 * ((r >> 2) & 1) + 4 * (r >> 3) + (r & 3);
    const bf16* vbase = VT + ((size_t)((b * 8 + h) * 64) << 12);
#pragma unroll 1
    for (int kt = qt; kt >= 0; --kt) {
        const bool diag = (kt == qt);
#pragma unroll 1
        for (int ksub = 1; ksub >= 0; --ksub) {
            const int key0 = kt * 64 + 32 * ksub;
            bf16x8 kf[4], vf[2][2];
#pragma unroll
            for (int ks = 0; ks < 4; ++ks) kf[ks] = *(const bf16x8*)(PROJ + (RB + key0 + kperm) * 2048 + 1536 + 64 * h + 16 * ks + 8 * hh);
#pragma unroll
            for (int dt = 0; dt < 2; ++dt)
#pragma unroll
                for (int s = 0; s < 2; ++s) vf[dt][s] = *(const bf16x8*)(vbase + ((size_t)(32 * dt + r) << 12) + key0 + 16 * hh + 8 * s);
#pragma unroll
            for (int qs = 0; qs < 2; ++qs) {
                if (diag && ksub > qs) continue;
                f32x16 S;
#pragma unroll
                for (int i = 0; i < 16; ++i) S[i] = 0.f;
#pragma unroll
                for (int ks = 0; ks < 4; ++ks) S = __builtin_amdgcn_mfma_f32_32x32x16_bf16(kf[ks], qf[qs][ks], S, 0, 0, 0);
                const bool dmask = diag && (ksub == qs);
                float att[16]; float sp = 1.f;
#pragma unroll
                for (int i = 15; i >= 0; --i) {
                    const float z = S[i];
                    const float w = __builtin_amdgcn_exp2f(-fabsf(z)), rr = __builtin_amdgcn_rcpf(1.f + w), wr_ = w * rr;
                    float beta = z >= 0.f ? rr : wr_, om = z >= 0.f ? wr_ : rr;
                    if (dmask) { const bool valid = (16 * hh + i) < r; beta = valid ? beta : 0.f; om = valid ? om : 1.f; }
                    att[i] = beta * sp; sp *= om;
                }
                const float oth = __shfl_xor(sp, 32);
                const float Rq = qs == 0 ? R0 : R1;
                const float base = hh ? Rq : Rq * oth;
                const float Rn = Rq * (sp * oth);
                if (qs == 0) R0 = Rn; else R1 = Rn;
                v4u f0, f1;
                f0.x = pk2(att[0] * base, att[1] * base); f0.y = pk2(att[2] * base, att[3] * base); f0.z = pk2(att[4] * base, att[5] * base); f0.w = pk2(att[6] * base, att[7] * base);
                f1.x = pk2(att[8] * base, att[9] * base); f1.y = pk2(att[10] * base, att[11] * base); f1.z = pk2(att[12] * base, att[13] * base); f1.w = pk2(att[14] * base, att[15] * base);
                const bf16x8 a0 = __builtin_bit_cast(bf16x8, f0), a1 = __builtin_bit_cast(bf16x8, f1);
#pragma unroll
                for (int dt = 0; dt < 2; ++dt) { O[qs][dt] = __builtin_amdgcn_mfma_f32_32x32x16_bf16(a0, vf[dt][0], O[qs][dt], 0, 0, 0); O[qs][dt] = __builtin_amdgcn_mfma_f32_32x32x16_bf16(a1, vf[dt][1], O[qs][dt], 0, 0, 0); }
            }
        }
        if (__ballot(fmaxf(R0, R1) >= ATT_THR) == 0ull) break;
    }
#pragma unroll
    for (int qs = 0; qs < 2; ++qs)
#pragma unroll
        for (int dt = 0; dt < 2; ++dt)
#pragma unroll
            for (int i = 0; i < 16; ++i) { const int qr = 32 * qs + (i & 3) + 8 * (i >> 2) + 4 * hh;
                Y[(RB + q0 + qr) * 1024 + 512 + 64 * h + 32 * dt + r] = (bf16)f2bf_dev(O[qs][dt][i]); }
}
__global__ void __launch_bounds__(512, 2) hymba_fwd(Args args) {
    __shared__ __attribute__((aligned(16))) unsigned char lds_raw[LDS_BYTES];
    cg::grid_group grid = cg::this_grid();
    LAS unsigned char* lds = (LAS unsigned char*)lds_raw;
#define PHASE_IDS int tid = threadIdx.x; asm volatile("" : "+v"(tid)); const int lane = tid & 63, wave = __builtin_amdgcn_readfirstlane(tid >> 6); (void)lane; (void)wave;
    const int G = gridDim.x, bid = blockIdx.x;
#define BLOCK_SYNC() do { asm volatile("s_waitcnt vmcnt(0) lgkmcnt(0)" ::: "memory"); __syncthreads(); } while (0)
#define GRID_SYNC() do { asm volatile("s_waitcnt vmcnt(0) lgkmcnt(0)" ::: "memory"); grid.sync(); __builtin_amdgcn_fence(__ATOMIC_ACQUIRE, "agent"); asm volatile("s_waitcnt vmcnt(0)" ::: "memory"); } while (0)
    const float* x = args.in[0]; const float* norm1_g = args.in[1]; const float* w_in = args.in[2]; const float* conv_w = args.in[3]; const float* conv_b = args.in[4];
    const float* lru_w_a = args.in[5]; const float* lru_b_a = args.in[6]; const float* lru_w_x = args.in[7]; const float* lru_b_x = args.in[8]; const float* lru_lambda = args.in[9];
    const float* lru_out_g = args.in[10]; const float* sb_out_g = args.in[11]; const float* w_out = args.in[12]; const float* norm2_g = args.in[13]; const float* w_up = args.in[14];
    const float* w_down = args.in[15]; const float* final_g = args.in[16];
    float* out = args.out; unsigned char* ws = args.ws;
    bf16* Win_t = (bf16*)(ws + WS_WIN); bf16* Wout_t = (bf16*)(ws + WS_WOUT); bf16* Wup_t = (bf16*)(ws + WS_WUP); bf16* Wdn_t = (bf16*)(ws + WS_WDN);
    bf16* WA_t = (bf16*)(ws + WS_WA); bf16* WX_t = (bf16*)(ws + WS_WX); float* CA2 = (float*)(ws + WS_CA2);
    float* AGGP = (float*)(ws + WS_AGGP); float* AGGH = (float*)(ws + WS_AGGH);
    bf16* XN = (bf16*)(ws + WS_XN); bf16* Y = (bf16*)(ws + WS_Y); bf16* HG = (bf16*)(ws + WS_HG); bf16* PG = (bf16*)(ws + WS_PG);
    bf16* PROJ = (bf16*)(ws + WS_PROJ); bf16* VT = (bf16*)(ws + WS_VT); bf16* U = (bf16*)(ws + WS_U);

    {
        PHASE_IDS
        LAS float* scr = (LAS float*)(lds + wave * 16384);
        const int gw = bid * 8 + wave, NGW = G * 8;
        constexpr int I_IN = (DM / 64) * (NIN / 32), I_OUT = (DM / 64) * (DM / 32), I_UP = (DM / 64) * (FF / 32), I_DN = (FF / 64) * (DM / 32), I_G = 8 * 2;
        constexpr int NITEMS = I_IN + I_OUT + I_UP + I_DN + 2 * I_G;
        for (int it = gw; it < NITEMS; it += NGW) {
            int r = it;
            if (r < I_IN) { p0_transpose_item(w_in, DM, NIN, Win_t, norm1_g, scr, r, lane); continue; } r -= I_IN;
            if (r < I_OUT) { const int k0 = 64 * (r / (DM / 32)); p0_transpose_item(w_out, DM, DM, Wout_t, k0 < LW ? lru_out_g : sb_out_g - LW, scr, r, lane); continue; } r -= I_OUT;
            if (r < I_UP) { p0_transpose_item(w_up, DM, FF, Wup_t, norm2_g, scr, r, lane); continue; } r -= I_UP;
            if (r < I_DN) { p0_transpose_item(w_down, FF, DM, Wdn_t, nullptr, scr, r, lane); continue; } r -= I_DN;
            if (r < I_G) { const int g = r >> 1; p0_transpose_item(lru_w_a + g * 4096, 64, 64, WA_t + g * 4096, nullptr, scr, r & 1, lane); continue; } r -= I_G;
            { const int g = r >> 1; p0_transpose_item(lru_w_x + g * 4096, 64, 64, WX_t + g * 4096, nullptr, scr, r & 1, lane); }
        }
        if (bid == 0) CA2[tid] = -8.f * LOG2E * log1pf(expf(-lru_lambda[tid]));
        for (int m = gw * 2; m < M; m += NGW * 2) {
            const f32x4* xr0 = (const f32x4*)(x + (size_t)m * DM) + lane; const f32x4* xr1 = xr0 + DM / 4;
            f32x4 v0[4], v1[4]; float s0 = 0.f, s1 = 0.f;
#pragma unroll
            for (int j = 0; j < 4; ++j) { v0[j] = xr0[64 * j]; v1[j] = xr1[64 * j]; }
#pragma unroll
            for (int j = 0; j < 4; ++j) { s0 += (v0[j].x * v0[j].x + v0[j].y * v0[j].y) + (v0[j].z * v0[j].z + v0[j].w * v0[j].w); s1 += (v1[j].x * v1[j].x + v1[j].y * v1[j].y) + (v1[j].z * v1[j].z + v1[j].w * v1[j].w); }
            const float r0 = 1.f / sqrtf(wave_sum(s0) * (1.f / DM) + EPS), r1 = 1.f / sqrtf(wave_sum(s1) * (1.f / DM) + EPS);
            unsigned long long* o0 = (unsigned long long*)(XN + (size_t)m * DM) + lane; unsigned long long* o1 = o0 + DM / 4;
#pragma unroll
            for (int j = 0; j < 4; ++j) { o0[64 * j] = (unsigned long long)pk2(v0[j].x * r0, v0[j].y * r0) | ((unsigned long long)pk2(v0[j].z * r0, v0[j].w * r0) << 32);
                                          o1[64 * j] = (unsigned long long)pk2(v1[j].x * r1, v1[j].y * r1) | ((unsigned long long)pk2(v1[j].z * r1, v1[j].w * r1) << 32); }
        }
    }
    GRID_SYNC();

#ifndef SKIP_G1
    {
        pg8::Gemm g{XN, Win_t, M, NIN, DM}; pg8::StaticOrder S; S.init(M, NIN, G, bid);
        pg8::EpiInProj E{PROJ, VT, 0.125f * LOG2E};
        pg8::gemm_phase<pg8::EpiInProj, pg8::StaticOrder, true, true>(lds, g, S, E);
    }
#endif
    GRID_SYNC();

    {
        PHASE_IDS
        LAS float* cwl = (LAS float*)lds;
        for (int i = tid; i < 2048; i += 512) cwl[i] = conv_w[i];
        cwl[2048 + tid] = conv_b[tid]; cwl[2560 + tid] = lru_b_a[tid]; cwl[3072 + tid] = lru_b_x[tid]; cwl[3584 + tid] = CA2[tid];
        __syncthreads();
        for (int it = bid; it < NB * 64; it += G) {
            const int b = it >> 6, c = it & 63;
            int li = lane; asm volatile("" : "+v"(li));
#ifndef SKIP_LRU
            lru_item(PROJ, WA_t, WX_t, lru_b_a, lru_b_x, CA2, cwl, HG, PG, AGGP, AGGH, b, c, wave, li);
#endif
#ifndef SKIP_ATT
            li = lane; asm volatile("" : "+v"(li));
            attn_item(PROJ, VT, Y, b, c, wave, li);
#endif
        }
    }
    GRID_SYNC();

    LAS float* part = (LAS float*)(lds + LDS_PART); LAS float* scl = (LAS float*)(lds + LDS_SCL); LAS float* rs = (LAS float*)(lds + LDS_RS);
    if (bid < M / 256) {
        const int pm = bid;
        const int b = pm >> 4, c0 = (pm & 15) * 4;
        {
            PHASE_IDS
            LAS float* cl = (LAS float*)lds;
            const float* ap = AGGP + (size_t)b * 64 * 512 + tid; const float* ah = AGGH + (size_t)b * 64 * 512 + tid;
            float st = 0.f;
#pragma unroll 8
            for (int j = 0; j < c0; ++j) st = ap[j * 512] * st + ah[j * 512];
#pragma unroll
            for (int jj = 0; jj < 4; ++jj) { cl[jj * 512 + tid] = st; st = ap[(c0 + jj) * 512] * st + ah[(c0 + jj) * 512]; }
            BLOCK_SYNC();
            const LAS float* cw = cl + (wave >> 1) * 512 + 8 * lane;
            const f32x4 c0v = *(const LAS f32x4*)cw, c1v = *(const LAS f32x4*)(cw + 4);
#pragma unroll 1
            for (int r4 = 0; r4 < 32; r4 += 4) {
                v4u hv[4], pv[4], yv[4];
#pragma unroll
                for (int k = 0; k < 4; ++k) { const size_t row = (size_t)pm * 256 + wave * 32 + r4 + k;
                    hv[k] = *(const v4u*)(HG + row * 512 + 8 * lane); pv[k] = *(const v4u*)(PG + row * 512 + 8 * lane); yv[k] = *(const v4u*)(Y + row * 1024 + 512 + 8 * lane); }
#pragma unroll
                for (int k = 0; k < 4; ++k) { const int rl = wave * 32 + r4 + k; const size_t row = (size_t)pm * 256 + rl;
                    f32x4 y0 = (f32x4){bflo(hv[k].x), bfhi(hv[k].x), bflo(hv[k].y), bfhi(hv[k].y)} + (f32x4){bflo(pv[k].x), bfhi(pv[k].x), bflo(pv[k].y), bfhi(pv[k].y)} * c0v;
                    f32x4 y1 = (f32x4){bflo(hv[k].z), bfhi(hv[k].z), bflo(hv[k].w), bfhi(hv[k].w)} + (f32x4){bflo(pv[k].z), bfhi(pv[k].z), bflo(pv[k].w), bfhi(pv[k].w)} * c1v;
                    float sa = (y0[0] * y0[0] + y0[1] * y0[1]) + (y0[2] * y0[2] + y0[3] * y0[3]) + (y1[0] * y1[0] + y1[1] * y1[1]) + (y1[2] * y1[2] + y1[3] * y1[3]);
                    const f32x4 s0 = {bflo(yv[k].x), bfhi(yv[k].x), bflo(yv[k].y), bfhi(yv[k].y)}, s1 = {bflo(yv[k].z), bfhi(yv[k].z), bflo(yv[k].w), bfhi(yv[k].w)};
                    float sb = (s0[0] * s0[0] + s0[1] * s0[1]) + (s0[2] * s0[2] + s0[3] * s0[3]) + (s1[0] * s1[0] + s1[1] * s1[1]) + (s1[2] * s1[2] + s1[3] * s1[3]);
                    sa = wave_sum(sa); sb = wave_sum(sb);
                    const float ra = 1.f / sqrtf(sa * (1.f / LW) + EPS), rb = 1.f / sqrtf(sb * (1.f / LW) + EPS);
                    y0 = y0 * ra; y1 = y1 * ra;
                    v4u o; o.x = pk2(y0[0], y0[1]); o.y = pk2(y0[2], y0[3]); o.z = pk2(y1[0], y1[1]); o.w = pk2(y1[2], y1[3]);
                    *(v4u*)(Y + row * 1024 + 8 * lane) = o;
                    if (lane == 0) { scl[rl * 2] = 1.f / rb; scl[rl * 2 + 1] = rb; } }
            }
            BLOCK_SYNC();
        }
#ifndef SKIP_G3
        {
            pg8::Gemm g{Y, Wout_t, M, DM, DM}; pg8::RowOrder S{pm, DM / 256};
            pg8::EpiOut E{x, out, XN, scl, part};
#ifndef SKIP_OUT
            pg8::gemm_phase<pg8::EpiOut, pg8::RowOrder, true, true>(lds, g, S, E);
#endif
            BLOCK_SYNC();
            PHASE_IDS
            if (tid < 256) { float s = 0.f;
#pragma unroll
                for (int k = 0; k < 16; ++k) s += part[k * 256 + tid];
                rs[tid] = 1.f / sqrtf(s * (1.f / DM) + EPS); }
            BLOCK_SYNC();
        }
        {
            pg8::Gemm g{XN, Wup_t, M, FF, DM}; pg8::RowOrder S{pm, FF / 256};
            pg8::EpiUp E{U, rs};
#ifndef SKIP_UP
            pg8::gemm_phase<pg8::EpiUp, pg8::RowOrder, true, true>(lds, g, S, E);
#endif
            BLOCK_SYNC();
        }
        {
            pg8::Gemm g{U, Wdn_t, M, DM, FF}; pg8::RowOrder S{pm, DM / 256};
            pg8::EpiDown E{out, part};
#ifndef SKIP_DOWN
            pg8::gemm_phase<pg8::EpiDown, pg8::RowOrder, true, true>(lds, g, S, E);
#endif
            BLOCK_SYNC();
            PHASE_IDS
            if (tid < 256) { float s = 0.f;
#pragma unroll
                for (int k = 0; k < 16; ++k) s += part[k * 256 + tid];
                rs[tid] = 1.f / sqrtf(s * (1.f / DM) + EPS); }
            BLOCK_SYNC();
        }
#endif
        {
            PHASE_IDS
            f32x4 fg[4];
#pragma unroll
            for (int j = 0; j < 4; ++j) fg[j] = *((const f32x4*)final_g + lane + 64 * j);
#pragma unroll 1
            for (int r2 = 0; r2 < 32; r2 += 2) {
                const int rl = wave * 32 + r2; f32x4* p0 = (f32x4*)(out + ((size_t)pm * 256 + rl) * DM) + lane; f32x4* p1 = p0 + DM / 4;
                f32x4 v0[4], v1[4];
#pragma unroll
                for (int j = 0; j < 4; ++j) { v0[j] = p0[64 * j]; v1[j] = p1[64 * j]; }
                const float a0 = rs[rl], a1 = rs[rl + 1];
#pragma unroll
                for (int j = 0; j < 4; ++j) { p0[64 * j] = v0[j] * a0 * fg[j]; p1[64 * j] = v1[j] * a1 * fg[j]; }
            }
            BLOCK_SYNC();
        }
    }
}

extern "C" void kernel_launch(void* const* d_in, const int* in_sizes, int n_in, void* d_out, int out_size, void* d_ws, size_t ws_size, hipStream_t stream) {
    static int grid = 0;
    if (grid == 0) {
        if (n_in != 17 || in_sizes[0] != M * DM || out_size != M * DM || ws_size < WS_END) { fprintf(stderr, "kernel_launch: unexpected shapes (n_in %d, in0 %d, out %d, ws %zu); nothing launched\n", n_in, n_in > 0 ? in_sizes[0] : -1, out_size, ws_size); grid = -1; return; }
        int dev = 0, cus = 0, per_cu = 0;
        if (hipGetDevice(&dev) != hipSuccess || hipDeviceGetAttribute(&cus, hipDeviceAttributeMultiprocessorCount, dev) != hipSuccess) { grid = -1; return; }
        if (hipOccupancyMaxActiveBlocksPerMultiprocessor(&per_cu, (const void*)hymba_fwd, 512, 0) != hipSuccess || per_cu < 1) { fprintf(stderr, "kernel_launch: occupancy query says %d blocks/CU\n", per_cu); per_cu = 1; }
        (void)hipGetLastError();
        grid = cus * 1;
        if (grid != M / 256) { fprintf(stderr, "kernel_launch: built for a 256-CU device (one 256-row tile per workgroup), found %d CUs; nothing launched\n", cus); grid = -1; return; }
    }
    if (grid < 0) return;
    Args a{};
    for (int i = 0; i < 17; ++i) a.in[i] = (const float*)d_in[i];
    a.out = (float*)d_out; a.ws = (unsigned char*)d_ws;
    void* kargs[] = {&a};
    hipError_t e = hipLaunchCooperativeKernel((const void*)hymba_fwd, dim3(grid), dim3(512), kargs, 0, stream);
    if (e != hipSuccess) fprintf(stderr, "kernel_launch: cooperative launch failed: %s (grid %d)\n", hipGetErrorString(e), grid);
}
```
